# Optimizing an MI355X kernel written in HIP

```python
import math
import jax, jax.numpy as jnp
from jax import lax
import numpy as np

D_MODEL = 2048
BATCH = 2
SEQ = 16384
DEPTH = 2

SGU_GROUPS = 8
SGU_WIDTH = 1024
SGU_GROUP_DIM = SGU_WIDTH // SGU_GROUPS
CHUNK = 128
DIFF_HEADS = 8
DIFF_HEAD_DIM = 64
DIFF_V_DIM = 2 * DIFF_HEAD_DIM
DIFF_QK_WIDTH = DIFF_HEADS * 2 * DIFF_HEAD_DIM
DIFF_WIDTH = DIFF_HEADS * DIFF_V_DIM
Q_BLOCK = 128
N_BRANCHES = 2
IN_COLS = 2 * SGU_WIDTH + 2 * DIFF_QK_WIDTH + DIFF_WIDTH + N_BRANCHES * D_MODEL
N_GROUPS = 4
EXPERTS_PER_GROUP = 4
N_EXPERTS = N_GROUPS * EXPERTS_PER_GROUP
EXPERT_FF = 512
TOP_K_IN_GROUP = 2

RMS_EPS = 1e-6
LN_EPS = 1e-5

kernel_name = "hybrid_sgu_diffattn_hmoe_encoder"


def rmsnorm(x, g):
    xf = x.astype(jnp.float32)
    y = xf * lax.rsqrt(jnp.mean(xf * xf, axis=-1, keepdims=True) + RMS_EPS)
    return (y * g.astype(jnp.float32)).astype(x.dtype)


def layernorm(x, g, b):
    xf = x.astype(jnp.float32)
    mu = jnp.mean(xf, axis=-1, keepdims=True)
    var = jnp.mean(jnp.square(xf - mu), axis=-1, keepdims=True)
    y = (xf - mu) * lax.rsqrt(var + LN_EPS)
    return (y * g.astype(jnp.float32) + b.astype(jnp.float32)).astype(x.dtype)


def alibi_slopes(n_heads):
    return jnp.exp2(-8.0 * jnp.arange(1, n_heads + 1, dtype=jnp.float32) / n_heads)


def spatial_gating(u, v, ln_g, ln_b, w_s, b_s):
    B, S, _ = v.shape
    u = jax.nn.gelu(u)
    v = layernorm(jax.nn.gelu(v), ln_g, ln_b)
    vc = v.reshape(B, S // CHUNK, CHUNK, SGU_GROUPS, SGU_GROUP_DIM)
    mixed = jnp.einsum('gts,bnsgc->bntgc', w_s, vc) + b_s.T[None, None, :, :, None]
    return u * mixed.reshape(B, S, SGU_WIDTH)


def diff_attention(q, k, v, lam, slopes):
    B, S = q.shape[:2]
    nb = S // Q_BLOCK
    scale = DIFF_HEAD_DIM ** -0.5
    qb = q.reshape(B, nb, Q_BLOCK, DIFF_HEADS, 2, DIFF_HEAD_DIM).transpose(1, 0, 2, 3, 4, 5)
    starts = jnp.arange(nb, dtype=jnp.int32) * Q_BLOCK
    k_pos = jnp.arange(S, dtype=jnp.int32)

    def block(args):
        q_blk, start = args
        q_pos = start + jnp.arange(Q_BLOCK, dtype=jnp.int32)
        dist = jnp.abs(q_pos[:, None] - k_pos[None, :]).astype(jnp.float32)
        bias = -slopes[:, None, None] * dist[None]
        s = jnp.einsum('bqhmd,bkhmd->mbhqk', q_blk, k,
                       preferred_element_type=jnp.float32) * scale + bias
        p = jax.nn.softmax(s, axis=-1)
        w = p[0] - lam * p[1]
        return jnp.einsum('bhqk,bkhe->bqhe', w.astype(v.dtype), v)

    out = lax.map(block, (qb, starts))
    return out.transpose(1, 0, 2, 3, 4).reshape(B, S, DIFF_HEADS, DIFF_V_DIM)


def hier_moe(h, rg_w, rg_b, re_w, re_b, w1, w3, w2):
    B, S, D = h.shape
    t = h.reshape(B * S, D)
    g_logits = (t @ rg_w).astype(jnp.float32) + rg_b.astype(jnp.float32)
    g_prob = jax.nn.softmax(g_logits, axis=-1)
    g_w, g_idx = lax.top_k(g_prob, 1)
    e_logits = ((t @ re_w).astype(jnp.float32) + re_b.astype(jnp.float32)
                ).reshape(-1, N_GROUPS, EXPERTS_PER_GROUP)
    g_onehot = jax.nn.one_hot(g_idx[:, 0], N_GROUPS, dtype=jnp.float32)
    e_sel = jnp.einsum('tg,tge->te', g_onehot, e_logits)
    e_prob = jax.nn.softmax(e_sel, axis=-1)
    e_w, e_idx = lax.top_k(e_prob, TOP_K_IN_GROUP)
    e_w = e_w / jnp.sum(e_w, axis=-1, keepdims=True)
    weights = g_w * e_w
    experts = g_idx * EXPERTS_PER_GROUP + e_idx
    combine = jnp.einsum('tk,tke->et', weights,
                         jax.nn.one_hot(experts, N_EXPERTS, dtype=jnp.float32)).astype(t.dtype)

    def body(y, xs):
        w1_e, w3_e, w2_e, c_e = xs
        hid = jax.nn.silu(t @ w1_e) * (t @ w3_e)
        return y + c_e[:, None] * (hid @ w2_e), None

    y, _ = lax.scan(body, jnp.zeros_like(t), (w1, w3, w2, combine))
    return y.reshape(B, S, D)


def setup_inputs(seed: int = 0) -> dict:
    key = jax.random.key(seed)
    ks = jax.random.split(key, 24)
    f32 = jnp.float32

    def nrm(k, shape, scale):
        return jax.random.normal(k, shape, f32) * scale

    L, D = DEPTH, D_MODEL
    return {
        "x": nrm(ks[0], (BATCH, SEQ, D), 1.0),
        "norm1_g": 1.0 + nrm(ks[1], (L, D), 0.02),
        "w_in": nrm(ks[2], (L, D, IN_COLS), D ** -0.5),
        "b_gate": nrm(ks[3], (L, N_BRANCHES, D), 0.02),
        "sgu_ln_g": 1.0 + nrm(ks[4], (L, SGU_WIDTH), 0.02),
        "sgu_ln_b": nrm(ks[5], (L, SGU_WIDTH), 0.02),
        "sgu_w": nrm(ks[6], (L, SGU_GROUPS, CHUNK, CHUNK), CHUNK ** -0.5),
        "sgu_b": 1.0 + nrm(ks[7], (L, SGU_GROUPS, CHUNK), 0.02),
        "lam_q1": nrm(ks[8], (L, DIFF_HEAD_DIM), 0.1),
        "lam_k1": nrm(ks[9], (L, DIFF_HEAD_DIM), 0.1),
        "lam_q2": nrm(ks[10], (L, DIFF_HEAD_DIM), 0.1),
        "lam_k2": nrm(ks[11], (L, DIFF_HEAD_DIM), 0.1),
        "diff_norm_g": 1.0 + nrm(ks[12], (L, DIFF_V_DIM), 0.02),
        "w_proj_a": nrm(ks[13], (L, SGU_WIDTH, D), SGU_WIDTH ** -0.5),
        "w_proj_b": nrm(ks[14], (L, DIFF_WIDTH, D), DIFF_WIDTH ** -0.5),
        "w_out": nrm(ks[15], (L, D, D), D ** -0.5),
        "norm2_g": 1.0 + nrm(ks[16], (L, D), 0.02),
        "router_g_w": nrm(ks[17], (L, D, N_GROUPS), D ** -0.5),
        "router_g_b": nrm(ks[18], (L, N_GROUPS), 0.01),
        "router_e_w": nrm(ks[19], (L, D, N_EXPERTS), D ** -0.5),
        "router_e_b": nrm(ks[20], (L, N_EXPERTS), 0.01),
        "w1": nrm(ks[21], (L, N_EXPERTS, D, EXPERT_FF), D ** -0.5),
        "w3": nrm(ks[22], (L, N_EXPERTS, D, EXPERT_FF), D ** -0.5),
        "w2": nrm(ks[23], (L, N_EXPERTS, EXPERT_FF, D), EXPERT_FF ** -0.5),
        "final_g": 1.0 + nrm(jax.random.fold_in(key, 99), (D,), 0.02),
    }


def reference(x, norm1_g, w_in, b_gate, sgu_ln_g, sgu_ln_b, sgu_w, sgu_b,
              lam_q1, lam_k1, lam_q2, lam_k2, diff_norm_g, w_proj_a, w_proj_b,
              w_out, norm2_g, router_g_w, router_g_b, router_e_w, router_e_b,
              w1, w3, w2, final_g):
    B, S, D = x.shape
    slopes = alibi_slopes(DIFF_HEADS)
    splits = [SGU_WIDTH, 2 * SGU_WIDTH,
              2 * SGU_WIDTH + DIFF_QK_WIDTH,
              2 * SGU_WIDTH + 2 * DIFF_QK_WIDTH,
              2 * SGU_WIDTH + 2 * DIFF_QK_WIDTH + DIFF_WIDTH]
    for l in range(DEPTH):
        h = rmsnorm(x, norm1_g[l])
        z = h @ w_in[l]
        u_a, v_a, q, k, v_b, gate_logits = jnp.split(z, splits, axis=-1)

        a = spatial_gating(u_a, v_a, sgu_ln_g[l], sgu_ln_b[l], sgu_w[l], sgu_b[l])

        lam_init = 0.8 - 0.6 * math.exp(-0.3 * l)
        lam = (jnp.exp(jnp.sum(lam_q1[l].astype(jnp.float32) * lam_k1[l].astype(jnp.float32)))
               - jnp.exp(jnp.sum(lam_q2[l].astype(jnp.float32) * lam_k2[l].astype(jnp.float32)))
               + lam_init)
        qh = q.reshape(B, S, DIFF_HEADS, 2, DIFF_HEAD_DIM)
        kh = k.reshape(B, S, DIFF_HEADS, 2, DIFF_HEAD_DIM)
        vh = v_b.reshape(B, S, DIFF_HEADS, DIFF_V_DIM)
        o = diff_attention(qh, kh, vh, lam, slopes)
        o = rmsnorm(o, diff_norm_g[l]) * (1.0 - lam_init)
        b_out = o.reshape(B, S, DIFF_WIDTH)

        gates = jax.nn.sigmoid(gate_logits.reshape(B, S, N_BRANCHES, D) + b_gate[l])
        merged = gates[:, :, 0] * (a @ w_proj_a[l]) + gates[:, :, 1] * (b_out @ w_proj_b[l])
        x = x + merged @ w_out[l]

        h2 = rmsnorm(x, norm2_g[l])
        x = x + hier_moe(h2, router_g_w[l], router_g_b[l], router_e_w[l], router_e_b[l],
                         w1[l], w3[l], w2[l])
    return rmsnorm(x, final_g)
```

```cpp
#include <hip/hip_runtime.h>
#include <cstdio>
#include <cstdint>

#ifndef MK_N_LAUNCHES
#define MK_N_LAUNCHES 0
#endif

#define GAS __attribute__((address_space(1)))
#define LAS __attribute__((address_space(3)))
typedef unsigned short bf16_t;
typedef short bf16x8 __attribute__((ext_vector_type(8)));
typedef short s16x4 __attribute__((ext_vector_type(4)));
typedef short v4i16_t __attribute__((ext_vector_type(4)));
typedef float f32x2 __attribute__((ext_vector_type(2)));
typedef float f32x4 __attribute__((ext_vector_type(4)));
typedef float f32x16 __attribute__((ext_vector_type(16)));
typedef unsigned u32x2 __attribute__((ext_vector_type(2)));
typedef unsigned u32x4 __attribute__((ext_vector_type(4)));
typedef GAS unsigned gu32;
#define RLX_AGENT __ATOMIC_RELAXED, __HIP_MEMORY_SCOPE_AGENT

constexpr int D = 2048, BATCH = 2, SEQ = 16384, T = BATCH * SEQ, DEPTH = 2;
constexpr int ZW = 1024;
constexpr int NIN = 9216, NH = 8, NE = 16, FF = 512, NCLS = 24;
constexpr float RMS_EPS = 1e-6f, LN_EPS = 1e-5f;
constexpr float LOG2E = 1.4426950408889634f;
constexpr float QSCALE = 0.125f * LOG2E;
constexpr float SKIP_T2 = 48.0f;

constexpr size_t MiB = 1u << 20;
constexpr size_t WS_CTL = 0, CTL_ZERO_BYTES = 1 * MiB;
constexpr size_t WS_RWH = 1 * MiB, WS_RWL = 1 * MiB + 128 * 1024;
constexpr size_t WS_SGW = 1 * MiB + 256 * 1024;
constexpr size_t WS_TOKC = 2 * MiB;
constexpr size_t WS_LISTE = 3 * MiB;
constexpr size_t WS_LISTC = 5 * MiB;
constexpr size_t WS_WIN = 16 * MiB, WS_WA = 52 * MiB, WS_WB = 56 * MiB, WS_WOUT = 60 * MiB, WS_W13 = 68 * MiB, WS_W2T = 132 * MiB;
constexpr size_t WS_H = 164 * MiB;
constexpr size_t WS_Z = 292 * MiB;
constexpr size_t ZSTRIDE = (size_t)T * ZW;
constexpr size_t WS_G = 612 * MiB;
constexpr size_t WS_END = 868 * MiB;

constexpr int CW_BAR = 4096;
constexpr int CW_AQ = 8192;
constexpr int CW_KN = 8448;
constexpr int CW_CNTE = 9216;
constexpr int CW_CNTC = 13312;

constexpr int RING_BYTES = 131072;
constexpr int LDSCTL_OFF = RING_BYTES;
constexpr int MISC_OFF = LDSCTL_OFF + 64;
constexpr int MOETAB_OFF = LDSCTL_OFF + 256;
constexpr int LDS_BYTES = 147456;

typedef __bf16 bf16x2_t __attribute__((ext_vector_type(2)));
__device__ __forceinline__ unsigned cvt_pk_bf16(float lo, float hi) { const f32x2 v = {lo, hi}; const bf16x2_t b = __builtin_convertvector(v, bf16x2_t); return __builtin_bit_cast(unsigned, b); }
__device__ __forceinline__ float bf_lo(unsigned w) { return __uint_as_float(w << 16); }
__device__ __forceinline__ float bf_hi(unsigned w) { return __uint_as_float(w & 0xffff0000u); }
__device__ __forceinline__ float shx(float v, int o, int lane) { return __int_as_float(__builtin_amdgcn_ds_bpermute((lane ^ o) << 2, __float_as_int(v))); }
__device__ __forceinline__ float wave_sum(float v, int lane) {
#pragma unroll
    for (int o = 1; o < 64; o <<= 1) v += shx(v, o, lane);
    return v;
}
__device__ __forceinline__ float wave_max(float v, int lane) {
#pragma unroll
    for (int o = 1; o < 64; o <<= 1) v = fmaxf(v, shx(v, o, lane));
    return v;
}
__device__ __forceinline__ float gelu_tanh(float x) {
    const float u = x * (1.0f + 0.044715f * x * x);
    const float e = __builtin_amdgcn_exp2f(u * (-2.0f * 0.7978845608028654f * LOG2E));
    return x * __builtin_amdgcn_rcpf(1.0f + e);
}
__device__ __forceinline__ float sigmoidf_(float x) { return __builtin_amdgcn_rcpf(1.0f + __builtin_amdgcn_exp2f(-x * LOG2E)); }

__device__ __forceinline__ int lane_now() { int r; asm volatile("v_mbcnt_lo_u32_b32 %0, -1, 0\n\tv_mbcnt_hi_u32_b32 %0, -1, %0" : "=v"(r)); return r; }
#define XB_TMO      128
#define XB_XCNT(j)  (256  + 64 * (j))
#define XB_XSUB(j)  (1280 + 64 * (j))
#define XB_XGEN(j)  (2304 + 64 * (j))
#define XB_TOP      3328
#define XB_TOPGEN   3392
#define XCD_BAR_WORDS 3456
#define XB_SPIN_CAP (1u << 22)

__device__ __forceinline__ unsigned xb_ld(unsigned* p)              { return __hip_atomic_load(p, __ATOMIC_RELAXED, __HIP_MEMORY_SCOPE_AGENT); }
__device__ __forceinline__ unsigned xb_add(unsigned* p, unsigned v) { return __hip_atomic_fetch_add(p, v, __ATOMIC_RELAXED, __HIP_MEMORY_SCOPE_AGENT); }
__device__ __forceinline__ unsigned xb_xcc_id() { return (unsigned)__builtin_amdgcn_s_getreg((3 << 11) | 20) & 0xFu; }
#define XB_SPIN(cond, bar) do { unsigned _sp = 0; while (cond) { __builtin_amdgcn_s_sleep(1); \
    if ((++_sp & 255u) == 0u) { if (xb_ld(&(bar)[XB_TMO])) break; if (_sp > XB_SPIN_CAP) { atomicAdd(&(bar)[XB_TMO], 1u); break; } } } } while (0)

struct XcdBarrier { unsigned* bar; unsigned x; volatile LAS unsigned* st; };

__device__ __forceinline__ XcdBarrier xcd_barrier_post(unsigned* bar, volatile LAS unsigned* st) {
    XcdBarrier b; b.bar = bar; b.x = xb_xcc_id(); b.st = st;
    if (threadIdx.x == 0) (void)xb_add(&bar[XB_XCNT(b.x)], 1u);
    return b;
}
__device__ __forceinline__ void xcd_barrier_complete(unsigned* bar, unsigned x, unsigned& nloc, unsigned& nx) {
    const unsigned G = gridDim.x * gridDim.y * gridDim.z;
    unsigned sum, cnt, mine, sp = 0u;
    for (;;) {
        sum = 0u; cnt = 0u; mine = 0u;
#pragma unroll
        for (unsigned j = 0; j < 16; ++j) { const unsigned c = xb_ld(&bar[XB_XCNT(j)]); sum += c; cnt += (c > 0u) ? 1u : 0u; mine = (j == x) ? c : mine; }
        if (sum == G) break;
        __builtin_amdgcn_s_sleep(1);
        if ((++sp & 255u) == 0u) { if (xb_ld(&bar[XB_TMO])) break; if (sp > XB_SPIN_CAP) { atomicAdd(&bar[XB_TMO], 1u); break; } }
    }
    nloc = mine > 0u ? mine : 1u; nx = cnt > 0u ? cnt : 1u;
}
__device__ __forceinline__ void xcd_barrier(const XcdBarrier& b, const bool leader  ) {
    asm volatile("s_waitcnt vmcnt(0)" ::: "memory");
    __syncthreads();
    if (leader) {
        unsigned* bar = b.bar;
        __builtin_amdgcn_s_waitcnt(0);
        unsigned nloc = b.st[0], nx = b.st[1];
        if (nloc == 0u) { xcd_barrier_complete(bar, b.x, nloc, nx); b.st[0] = nloc; b.st[1] = nx; }
        const unsigned old = xb_add(&bar[XB_XSUB(b.x)], 1u);
        const unsigned gen = old / nloc;
        if (old + 1u == (gen + 1u) * nloc) {
            __builtin_amdgcn_fence(__ATOMIC_RELEASE, "agent");
            asm volatile("s_waitcnt vmcnt(0)" ::: "memory");
            const unsigned og = xb_add(&bar[XB_TOP], 1u);
            const unsigned tg = og / nx;
            if (og + 1u == (tg + 1u) * nx) xb_add(&bar[XB_TOPGEN], 1u);
            else XB_SPIN(xb_ld(&bar[XB_TOPGEN]) == tg, bar);
            __builtin_amdgcn_fence(__ATOMIC_ACQUIRE, "agent");
            xb_add(&bar[XB_XGEN(b.x)], 1u);
            asm volatile("s_waitcnt vmcnt(0)" ::: "memory");
        } else {
            XB_SPIN(xb_ld(&bar[XB_XGEN(b.x)]) == gen, bar);
            __builtin_amdgcn_fence(__ATOMIC_ACQUIRE, "agent");
            asm volatile("s_waitcnt vmcnt(0)" ::: "memory");
        }
    }
    __syncthreads();
}

namespace pg8 {
constexpr int BM = 256, BK = 64, HALF = 128, HTB = HALF * BK * 2, STAGE_BYTES = 8 * HTB, NXCD = 8, WGM = 8;
__host__ __device__ __forceinline__ int lds_byte(int r, int c) { const int st = (r >> 4) * 2 + (c >> 5), rr = r & 15, cc = c & 31, ob = rr * 64 + cc * 2; return st * 1024 + (ob ^ (((ob >> 9) & 1) << 5)); }
__host__ __device__ __forceinline__ void stage_rc(int b, int& R, int& C) { const int st = b / 1024, sb = b % 1024, swz = sb ^ (((sb >> 9) & 1) << 5); R = (st >> 1) * 16 + swz / 64; C = (st & 1) * 32 + (swz % 64) / 2; }
__host__ __device__ __forceinline__ int perm32(int rho) { const int n = rho >> 4, i = rho & 15; return 8 * (i >> 2) + 4 * n + (i & 3); }

typedef f32x4 Acc[2][2][4][2];

template <class Epi, class Sched, bool ALIGN_EPI>
__device__ __forceinline__ void gemm_phase(LAS unsigned char* lds, const int wid, const bf16_t* Aglob, const int lda, const int ldb, const int K, const Sched& S, const Epi& E) {
    typedef typename Sched::Unit Unit;
    int lane_ = lane_now(); asm volatile("" : "+v"(lane_));
    const int lane = lane_, tid = wid * 64 + lane, wr = wid >> 2, wc = wid & 3;
    int fr = lane & 15, fq = lane >> 4;
    const int nt = K / BK;
    unsigned voffB[2];
#pragma unroll
    for (int i = 0; i < 2; ++i) { int R, C; stage_rc(tid * 16 + i * 8192, R, C); const int Rb = Epi::PERM ? ((R & ~31) + perm32(R & 31)) : R; voffB[i] = (unsigned)(Rb * ldb + C) * 2u; }
    const size_t kstep = (size_t)(BK * 2);
    const size_t hstepB = (size_t)HALF * ldb * 2;
    const unsigned ldsw = (unsigned)wid * 1024u;
    const int aoff = lds_byte(wr * 64 + fr, fq * 8), boff = lds_byte(wc * 32 + fr, fq * 8);
#define PG8_SA(b, h) (((b) * 2 + (h)) * HTB)
#define PG8_SB(b, h) ((4 + (b) * 2 + (h)) * HTB)
#define PG8_STAGE(bufoff, gbase, v0, v1) do { \
        __builtin_amdgcn_global_load_lds((const unsigned*)((const char*)(gbase) + (v0)), (LAS unsigned*)(lds + (bufoff) + ldsw), 16, 0, 0); \
        __builtin_amdgcn_global_load_lds((const unsigned*)((const char*)(gbase) + (v1)), (LAS unsigned*)(lds + (bufoff) + ldsw + 8192), 16, 0, 0); } while (0)
#define PG8_LDA(dst, b, h) do { _Pragma("unroll") for (int m = 0; m < 4; ++m) _Pragma("unroll") for (int k = 0; k < 2; ++k) dst[m][k] = *(const LAS bf16x8*)(lds + PG8_SA(b, h) + aoff + m * 2048 + k * 1024); } while (0)
#define PG8_LDB(dst, b, h) do { _Pragma("unroll") for (int n = 0; n < 2; ++n) _Pragma("unroll") for (int k = 0; k < 2; ++k) dst[n][k] = *(const LAS bf16x8*)(lds + PG8_SB(b, h) + boff + n * 2048 + k * 1024); } while (0)
#define PG8_MMA(ai, bj, At, Bt) do { __builtin_amdgcn_s_setprio(1); _Pragma("unroll") for (int m = 0; m < 4; ++m) _Pragma("unroll") for (int n = 0; n < 2; ++n) _Pragma("unroll") for (int k = 0; k < 2; ++k) \
        acc[ai][bj][m][n] = __builtin_amdgcn_mfma_f32_16x16x32_bf16(Bt[n][k], At[m][k], acc[ai][bj][m][n], 0, 0, 0); __builtin_amdgcn_s_setprio(0); } while (0)
#define PG8_WAIT_V(n) asm volatile("s_waitcnt vmcnt(" #n ")" ::: "memory")
#define PG8_WAIT_L(n) asm volatile("s_waitcnt lgkmcnt(" #n ")" ::: "memory")
#define PG8_BAR __builtin_amdgcn_s_barrier()
#define PG8_SCHED __builtin_amdgcn_sched_barrier(0)
#define PG8_SETA(dst, u) do { int t_ = lane; asm volatile("" : "+v"(t_)); t_ += wid * 64;   \
        _Pragma("unroll") for (int i_ = 0; i_ < 2; ++i_) { int R_, C_; stage_rc(t_ * 16 + i_ * 8192, R_, C_); \
        _Pragma("unroll") for (int h_ = 0; h_ < 2; ++h_) dst[h_][i_] = ((unsigned)S.arow(u, h_ * HALF + R_) * (unsigned)lda + (unsigned)C_) * 2u; } \
        asm volatile("" : "+v"(dst[0][0]), "+v"(dst[0][1]), "+v"(dst[1][0]), "+v"(dst[1][1])); } while (0)
    Unit cur, nxt; int ui = 0;
    if (!S.next(0, cur)) return;
    Acc acc;
#pragma unroll
    for (int a = 0; a < 2; ++a)
#pragma unroll
        for (int b = 0; b < 2; ++b)
#pragma unroll
            for (int m = 0; m < 4; ++m)
#pragma unroll
                for (int n = 0; n < 2; ++n) acc[a][b][m][n] = (f32x4){0.f, 0.f, 0.f, 0.f};
    bf16x8 At[4][2], B0[2][2], B1[2][2];
    unsigned vAc[2][2];
    PG8_SETA(vAc, cur);
    const char* const Ab = (const char*)Aglob;
    const char* cB0 = S.bptr(cur, 0); const char* cB1 = S.bptr(cur, 1);
    PG8_STAGE(PG8_SB(0, 0), cB0, voffB[0], voffB[1]); PG8_STAGE(PG8_SB(0, 1), cB0 + hstepB, voffB[0], voffB[1]);
    PG8_STAGE(PG8_SA(0, 0), Ab, vAc[0][0], vAc[0][1]); PG8_STAGE(PG8_SA(0, 1), Ab, vAc[1][0], vAc[1][1]);
    if (wr == 1) PG8_BAR;
    PG8_WAIT_V(2); PG8_BAR;
    PG8_STAGE(PG8_SB(1, 0), cB1, voffB[0], voffB[1]); PG8_STAGE(PG8_SA(1, 0), Ab + kstep, vAc[0][0], vAc[0][1]); PG8_STAGE(PG8_SB(1, 1), cB1 + hstepB, voffB[0], voffB[1]);
    PG8_WAIT_V(6); PG8_BAR;
    for (;;) {
        const bool has_next = S.next(ui + 1, nxt);
        unsigned vAn[2][2];
        const char* nB0 = cB0; const char* nB1 = cB1;
        if (has_next) { nB0 = S.bptr(nxt, 0); nB1 = S.bptr(nxt, 1); }
#define PG8_KBODY(a1, a2, a3, b2, b3, x00, x01, x10, x11) do { \
              \
            PG8_LDB(B0, 0, 0); PG8_LDB(B1, 0, 1); PG8_SCHED; PG8_LDA(At, 0, 0); PG8_STAGE(PG8_SA(1, 1), a1, vAc[1][0], vAc[1][1]); \
            PG8_WAIT_V(8); PG8_WAIT_L(0); PG8_BAR; PG8_MMA(0, 0, At, B0); PG8_MMA(0, 1, At, B1); PG8_BAR; PG8_SCHED; \
              \
            PG8_LDA(At, 0, 1); PG8_STAGE(PG8_SB(0, 0), b2, voffB[0], voffB[1]); PG8_STAGE(PG8_SB(0, 1), (b2) + hstepB, voffB[0], voffB[1]); PG8_STAGE(PG8_SA(0, 0), a2, x00, x01); \
            PG8_WAIT_V(8); PG8_WAIT_L(0); PG8_BAR; PG8_MMA(1, 0, At, B0); PG8_MMA(1, 1, At, B1); PG8_BAR; PG8_SCHED; \
              \
            PG8_LDB(B0, 1, 0); PG8_LDB(B1, 1, 1); PG8_SCHED; PG8_LDA(At, 1, 0); PG8_STAGE(PG8_SA(0, 1), a2, x10, x11); \
            PG8_WAIT_V(8); PG8_WAIT_L(0); PG8_BAR; PG8_MMA(0, 0, At, B0); PG8_MMA(0, 1, At, B1); PG8_BAR; PG8_SCHED; \
              \
            PG8_LDA(At, 1, 1); PG8_STAGE(PG8_SB(1, 0), b3, voffB[0], voffB[1]); PG8_STAGE(PG8_SB(1, 1), (b3) + hstepB, voffB[0], voffB[1]); PG8_STAGE(PG8_SA(1, 0), a3, x00, x01); \
            PG8_WAIT_V(8); PG8_WAIT_L(0); PG8_BAR; PG8_MMA(1, 0, At, B0); PG8_MMA(1, 1, At, B1); PG8_BAR; PG8_SCHED; } while (0)
        for (int t = 0; t < nt - 2; t += 2) {
            const char* a1 = Ab + (size_t)(t + 1) * kstep; const char* a2 = a1 + kstep; const char* a3 = a2 + kstep;
            const char* b2 = S.bptr(cur, t + 2); const char* b3 = S.bptr(cur, t + 3);
            PG8_KBODY(a1, a2, a3, b2, b3, vAc[0][0], vAc[0][1], vAc[1][0], vAc[1][1]);
        }
        {
            if (has_next) { PG8_SETA(vAn, nxt); }
            else {
#pragma unroll
                for (int h_ = 0; h_ < 2; ++h_)
#pragma unroll
                    for (int i_ = 0; i_ < 2; ++i_) vAn[h_][i_] = vAc[h_][i_];
            }
            const char* a1 = Ab + (size_t)(nt - 1) * kstep; const char* a2 = Ab; const char* a3 = Ab + kstep;
            PG8_KBODY(a1, a2, a3, nB0, nB1, vAn[0][0], vAn[0][1], vAn[1][0], vAn[1][1]);
        }
#undef PG8_KBODY
        if constexpr (ALIGN_EPI) { if (wr == 0) PG8_BAR; }
        { int l2_ = lane; asm volatile("" : "+v"(l2_)); fr = l2_ & 15; fq = l2_ >> 4; }
        E(acc, cur, wr, wc, fr, fq);
        if (!has_next) break;
#pragma unroll
        for (int a = 0; a < 2; ++a)
#pragma unroll
            for (int b = 0; b < 2; ++b)
#pragma unroll
                for (int m = 0; m < 4; ++m)
#pragma unroll
                    for (int n = 0; n < 2; ++n) acc[a][b][m][n] = (f32x4){0.f, 0.f, 0.f, 0.f};
        cur = nxt; cB0 = nB0; cB1 = nB1; ++ui;
#pragma unroll
        for (int h_ = 0; h_ < 2; ++h_)
#pragma unroll
            for (int i_ = 0; i_ < 2; ++i_) vAc[h_][i_] = vAn[h_][i_];
        if constexpr (ALIGN_EPI) { if (wr == 1) PG8_BAR; }
    }
    PG8_WAIT_V(0);
    if constexpr (!ALIGN_EPI) { if (wr == 0) PG8_BAR; }
    PG8_BAR;
#undef PG8_SA
#undef PG8_SB
#undef PG8_STAGE
#undef PG8_LDA
#undef PG8_LDB
#undef PG8_MMA
#undef PG8_WAIT_V
#undef PG8_WAIT_L
#undef PG8_BAR
#undef PG8_SCHED
#undef PG8_SETA
}

struct DenseOrder {
    struct Unit { int pm, pn; };
    int nM, nN, nwg, G, c; const char* Bt; int ldb;
    __device__ __forceinline__ void init(int M, int N, int G_, int c_, const bf16_t* B, int ldb_) { nM = M / BM; nN = N / BM; nwg = nM * nN; G = G_; c = c_; Bt = (const char*)B; ldb = ldb_; }
    __device__ __forceinline__ bool next(int i, Unit& u) const {
        const long L = (long)i * G + c; if (L >= nwg) return false;
        int wgid = (int)L; { const int q = nwg / NXCD, r = nwg % NXCD, xcd = wgid % NXCD, off = wgid / NXCD; wgid = (xcd < r ? xcd * (q + 1) : r * (q + 1) + (xcd - r) * q) + off; }
        const int nig = WGM * nN, gid = wgid / nig, fm = gid * WGM, gsz = (nM - fm) < WGM ? (nM - fm) : WGM;
        u.pm = fm + ((wgid % nig) % gsz); u.pn = (wgid % nig) / gsz; return true;
    }
    __device__ __forceinline__ int arow(const Unit& u, int r) const { return u.pm * BM + r; }
    __device__ __forceinline__ const char* bptr(const Unit& u, int t) const { return Bt + ((size_t)u.pn * BM * ldb + (size_t)t * BK) * 2; }
};

struct MoeUnit { int j, rt, pn, n; const char* B0; const char* B1; };
struct UpOrder {
    typedef MoeUnit Unit;
    int G, c; const LAS int* tab; const int* lists; const char* Bt;
    __device__ __forceinline__ bool next(int i, Unit& u) const {
        const int L = i * G + c; const int rtg = L >> 2; const int total = __builtin_amdgcn_readfirstlane(tab[NE]);
        if (rtg >= total) return false;
        int j = 0;
#pragma unroll 1
        for (int q = 1; q < NE; ++q) { if (__builtin_amdgcn_readfirstlane(tab[q]) <= rtg) j = q; }
        u.j = j; u.rt = rtg - __builtin_amdgcn_readfirstlane(tab[j]); u.pn = L & 3; u.n = __builtin_amdgcn_readfirstlane(tab[32 + j]);
        u.B0 = Bt + ((size_t)(j * 4 + u.pn) * 256 * 2048) * 2; u.B1 = u.B0; return true;
    }
    __device__ __forceinline__ int arow(const Unit& u, int r) const { int idx = u.rt * 256 + r; idx = idx < u.n ? idx : u.n - 1; return ((const GAS int*)lists)[(size_t)u.j * T + idx] >> 1; }
    __device__ __forceinline__ const char* bptr(const Unit& u, int t) const { return u.B0 + (size_t)t * 128; }
};
struct DownOrder {
    typedef MoeUnit Unit;
    int G, c; const LAS int* tab; const int* lists; const char* Bt;
    __device__ __forceinline__ bool next(int i, Unit& u) const {
        const int L = i * G + c; const int rtg = L >> 3; const int total = __builtin_amdgcn_readfirstlane(tab[NCLS]);
        if (rtg >= total) return false;
        int j = 0;
#pragma unroll 1
        for (int q = 1; q < NCLS; ++q) { if (__builtin_amdgcn_readfirstlane(tab[q]) <= rtg) j = q; }
        u.j = j; u.rt = rtg - __builtin_amdgcn_readfirstlane(tab[j]); u.pn = L & 7; u.n = __builtin_amdgcn_readfirstlane(tab[32 + j]);
        const int g = j / 6, p = j % 6; const int lo = p < 3 ? 0 : (p < 5 ? 1 : 2); const int hi = p < 3 ? p + 1 : (p < 5 ? p - 1 : 3);
        u.B0 = Bt + ((size_t)((g * 4 + lo) * 2048 + u.pn * 256) * 512) * 2; u.B1 = Bt + ((size_t)((g * 4 + hi) * 2048 + u.pn * 256) * 512) * 2; return true;
    }
    __device__ __forceinline__ int arow(const Unit& u, int r) const { int idx = u.rt * 256 + r; idx = idx < u.n ? idx : u.n - 1; return ((const GAS int*)lists)[(size_t)u.j * T + idx]; }
    __device__ __forceinline__ const char* bptr(const Unit& u, int t) const { return t < 8 ? u.B0 + (size_t)t * 128 : u.B1 + (size_t)(t - 8) * 128; }
};

__device__ __forceinline__ u32x4 pack8(f32x4 v0, f32x4 v1) { u32x4 w; w.x = cvt_pk_bf16(v0[0], v0[1]); w.y = cvt_pk_bf16(v0[2], v0[3]); w.z = cvt_pk_bf16(v1[0], v1[1]); w.w = cvt_pk_bf16(v1[2], v1[3]); return w; }
__device__ __forceinline__ void unpack8(u32x4 w, f32x4& v0, f32x4& v1) { v0 = (f32x4){bf_lo(w.x), bf_hi(w.x), bf_lo(w.y), bf_hi(w.y)}; v1 = (f32x4){bf_lo(w.z), bf_hi(w.z), bf_lo(w.w), bf_hi(w.w)}; }

struct EpiZ {
    static constexpr bool PERM = true;
    bf16_t* Z; bf16_t* G; const float* bgate;
    template <class U> __device__ __forceinline__ void operator()(const Acc& acc, const U& u, int wr, int wc, int fr, int fq) const {
        const int pn = u.pn; const int row0 = u.pm * BM + wr * 64 + fr;
        if (pn < 20) {
            const int tb = pn >> 2; bf16_t* base = Z + (size_t)tb * ZSTRIDE; const int col0 = (pn & 3) * 256 + wc * 32 + 8 * fq;
#pragma unroll
            for (int ai = 0; ai < 2; ++ai)
#pragma unroll
                for (int m = 0; m < 4; ++m) { bf16_t* rowp = base + (size_t)(row0 + ai * HALF + m * 16) * ZW + col0;
#pragma unroll
                    for (int bj = 0; bj < 2; ++bj) { f32x4 v0 = acc[ai][bj][m][0], v1 = acc[ai][bj][m][1];
                        if (tb < 2) {
#pragma unroll
                            for (int e = 0; e < 4; ++e) { v0[e] = gelu_tanh(v0[e]); v1[e] = gelu_tanh(v1[e]); }
                        } else if (tb == 2) { v0 = v0 * QSCALE; v1 = v1 * QSCALE; }
                        *(GAS u32x4*)(rowp + bj * HALF) = pack8(v0, v1); } }
        } else {
            const int gc0 = (pn - 20) * 256 + wc * 32 + 8 * fq;
            f32x4 bv[2][2];
#pragma unroll
            for (int bj = 0; bj < 2; ++bj)
#pragma unroll
                for (int n = 0; n < 2; ++n) bv[bj][n] = *(const GAS f32x4*)(bgate + gc0 + bj * HALF + 4 * n);
#pragma unroll
            for (int ai = 0; ai < 2; ++ai)
#pragma unroll
                for (int m = 0; m < 4; ++m) { bf16_t* rowp = G + (size_t)(row0 + ai * HALF + m * 16) * 4096 + gc0;
#pragma unroll
                    for (int bj = 0; bj < 2; ++bj) { f32x4 v0 = acc[ai][bj][m][0] + bv[bj][0], v1 = acc[ai][bj][m][1] + bv[bj][1];
#pragma unroll
                        for (int e = 0; e < 4; ++e) { v0[e] = sigmoidf_(v0[e]); v1[e] = sigmoidf_(v1[e]); }
                        *(GAS u32x4*)(rowp + bj * HALF) = pack8(v0, v1); } }
        }
    }
};
template <bool ADD> struct EpiProj {
    static constexpr bool PERM = true;
    bf16_t* M; const bf16_t* G; int goff;
    template <class U> __device__ __forceinline__ void operator()(const Acc& acc, const U& u, int wr, int wc, int fr, int fq) const {
        const int row0 = u.pm * BM + wr * 64 + fr; const int col0 = u.pn * BM + wc * 32 + 8 * fq;
#pragma unroll
        for (int ai = 0; ai < 2; ++ai)
#pragma unroll
            for (int m = 0; m < 4; ++m) { const size_t r = (size_t)(row0 + ai * HALF + m * 16);
#pragma unroll
                for (int bj = 0; bj < 2; ++bj) { const int c = col0 + bj * HALF;
                    f32x4 g0, g1; unpack8(*(const GAS u32x4*)(G + r * 4096 + goff + c), g0, g1);
                    f32x4 v0 = acc[ai][bj][m][0] * g0, v1 = acc[ai][bj][m][1] * g1;
                    if (ADD) { f32x4 p0, p1; unpack8(*(const GAS u32x4*)(M + r * D + c), p0, p1); v0 = v0 + p0; v1 = v1 + p1; }
                    *(GAS u32x4*)(M + r * D + c) = pack8(v0, v1); } }
    }
};
struct EpiRes {
    static constexpr bool PERM = false;
    const float* base; float* out;
    template <class U> __device__ __forceinline__ void operator()(const Acc& acc, const U& u, int wr, int wc, int fr, int fq) const {
        const int row0 = u.pm * BM + wr * 64 + fr; const int col0 = u.pn * BM + wc * 32 + 4 * fq;
#pragma unroll
        for (int ai = 0; ai < 2; ++ai)
#pragma unroll
            for (int m = 0; m < 4; ++m) { const size_t off = (size_t)(row0 + ai * HALF + m * 16) * D + col0;
#pragma unroll
                for (int bj = 0; bj < 2; ++bj)
#pragma unroll
                    for (int n = 0; n < 2; ++n) { const f32x4 b = *(const GAS f32x4*)(base + off + bj * HALF + n * 16); *(GAS f32x4*)(out + off + bj * HALF + n * 16) = b + acc[ai][bj][m][n]; } }
    }
};
struct EpiUp {
    static constexpr bool PERM = true;
    bf16_t* HID; const float* tokc; const int* lists;
    template <class U> __device__ __forceinline__ void operator()(const Acc& acc, const U& u, int wr, int wc, int fr, int fq) const {
        const int j0 = u.pn * 128 + wc * 32 + 8 * fq;
#pragma unroll
        for (int ai = 0; ai < 2; ++ai)
#pragma unroll
            for (int m = 0; m < 4; ++m) { const int idx = u.rt * 256 + ai * HALF + wr * 64 + m * 16 + fr;
                if (idx < u.n) { const int entry = ((const GAS int*)lists)[(size_t)u.j * T + idx]; const float cw = ((const GAS float*)tokc)[entry];
                    f32x4 g0 = acc[ai][0][m][0], g1 = acc[ai][0][m][1]; const f32x4 u0 = acc[ai][1][m][0], u1 = acc[ai][1][m][1];
#pragma unroll
                    for (int e = 0; e < 4; ++e) { g0[e] = g0[e] * sigmoidf_(g0[e]) * u0[e] * cw; g1[e] = g1[e] * sigmoidf_(g1[e]) * u1[e] * cw; }
                    *(GAS u32x4*)(HID + (size_t)entry * FF + j0) = pack8(g0, g1); } }
    }
};
struct EpiDown {
    static constexpr bool PERM = false;
    float* out; const int* lists;
    template <class U> __device__ __forceinline__ void operator()(const Acc& acc, const U& u, int wr, int wc, int fr, int fq) const {
        const int col0 = u.pn * BM + wc * 32 + 4 * fq;
#pragma unroll
        for (int ai = 0; ai < 2; ++ai)
#pragma unroll
            for (int m = 0; m < 4; ++m) { const int idx = u.rt * 256 + ai * HALF + wr * 64 + m * 16 + fr;
                if (idx < u.n) { const int tok = ((const GAS int*)lists)[(size_t)u.j * T + idx]; float* rowp = out + (size_t)tok * D + col0;
#pragma unroll
                    for (int bj = 0; bj < 2; ++bj)
#pragma unroll
                        for (int n = 0; n < 2; ++n) { GAS f32x4* p = (GAS f32x4*)(rowp + bj * HALF + n * 16); *p = *p + acc[ai][bj][m][n]; } } }
    }
};
}

__device__ __forceinline__ void rms_row_bf16(const float* xrow, const float* g, bf16_t* orow, int lane) {
    const GAS f32x4* xr = (const GAS f32x4*)xrow + lane; f32x4 v[8]; float s = 0.f;
#pragma unroll
    for (int j = 0; j < 8; ++j) { v[j] = xr[64 * j]; s += (v[j].x * v[j].x + v[j].y * v[j].y) + (v[j].z * v[j].z + v[j].w * v[j].w); }
    const float rstd = 1.0f / sqrtf(wave_sum(s, lane) * (1.f / D) + RMS_EPS);
    const GAS f32x4* gr = (const GAS f32x4*)g + lane; GAS u32x2* o8 = (GAS u32x2*)orow + lane;
#pragma unroll
    for (int j = 0; j < 8; ++j) { const f32x4 gg = gr[64 * j]; u32x2 w; w.x = cvt_pk_bf16(v[j].x * rstd * gg.x, v[j].y * rstd * gg.y); w.y = cvt_pk_bf16(v[j].z * rstd * gg.z, v[j].w * rstd * gg.w); o8[64 * j] = w; }
}
__device__ __forceinline__ void rms_row_f32(const float* xrow, const float* g, float* orow, int lane) {
    const GAS f32x4* xr = (const GAS f32x4*)xrow + lane; f32x4 v[8]; float s = 0.f;
#pragma unroll
    for (int j = 0; j < 8; ++j) { v[j] = xr[64 * j]; s += (v[j].x * v[j].x + v[j].y * v[j].y) + (v[j].z * v[j].z + v[j].w * v[j].w); }
    const float rstd = 1.0f / sqrtf(wave_sum(s, lane) * (1.f / D) + RMS_EPS);
    const GAS f32x4* gr = (const GAS f32x4*)g + lane; GAS f32x4* o = (GAS f32x4*)orow + lane;
#pragma unroll
    for (int j = 0; j < 8; ++j) { const f32x4 gg = gr[64 * j]; o[64 * j] = v[j] * rstd * gg; }
}
__device__ __forceinline__ void cvt_item(const float* Wsrc, int ldw, bf16_t* WTdst, int ldk, int lane) {
    float v[64];
#pragma unroll
    for (int k = 0; k < 64; ++k) v[k] = ((const GAS float*)Wsrc)[(size_t)k * ldw + lane];
    GAS bf16_t* dst = (GAS bf16_t*)WTdst + (size_t)lane * ldk;
#pragma unroll
    for (int c = 0; c < 8; ++c) { u32x4 w; w.x = cvt_pk_bf16(v[8 * c], v[8 * c + 1]); w.y = cvt_pk_bf16(v[8 * c + 2], v[8 * c + 3]); w.z = cvt_pk_bf16(v[8 * c + 4], v[8 * c + 5]); w.w = cvt_pk_bf16(v[8 * c + 6], v[8 * c + 7]); *(GAS u32x4*)(dst + 8 * c) = w; }
}

struct Ptrs {
    const float* in[25]; float* out; unsigned char* ws; int ph_lo, ph_hi;
};
enum { I_X = 0, I_N1G, I_WIN, I_BGATE, I_LNG, I_LNB, I_SGW, I_SGB, I_LQ1, I_LK1, I_LQ2, I_LK2, I_DNG, I_WPA, I_WPB, I_WOUT, I_N2G, I_RGW, I_RGB, I_REW, I_REB, I_W1, I_W3, I_W2, I_FG };

__device__ __forceinline__ const float* inptr(int i) {
    const __attribute__((address_space(4))) unsigned long long* tab = (const __attribute__((address_space(4))) unsigned long long*)__builtin_amdgcn_kernarg_segment_ptr();
    asm volatile("" : "+s"(i));
    return (const float*)(const GAS float*)tab[i];
}
__device__ __forceinline__ void p0_convert_norm(unsigned char* ws, int l, const float* xin, int gw, int NGW, int lane) {
    bf16_t* WIN = (bf16_t*)(ws + WS_WIN); bf16_t* WA = (bf16_t*)(ws + WS_WA); bf16_t* WB = (bf16_t*)(ws + WS_WB); bf16_t* WOUT = (bf16_t*)(ws + WS_WOUT);
    bf16_t* W13 = (bf16_t*)(ws + WS_W13); bf16_t* W2T = (bf16_t*)(ws + WS_W2T);
    const float* w_in = inptr(I_WIN) + (size_t)l * D * NIN; const float* wpa = inptr(I_WPA) + (size_t)l * ZW * D; const float* wpb = inptr(I_WPB) + (size_t)l * ZW * D;
    const float* wout = inptr(I_WOUT) + (size_t)l * D * D; const float* w1 = inptr(I_W1) + (size_t)l * NE * D * FF; const float* w3 = inptr(I_W3) + (size_t)l * NE * D * FF; const float* w2 = inptr(I_W2) + (size_t)l * NE * FF * D;
    constexpr int I_IN = 32 * 144, I_PA = 16 * 32, I_OUT = 32 * 32, I_W1E = 32 * 8, I_W2E = 8 * 32;
    constexpr int NITEMS = I_IN + 2 * I_PA + I_OUT + 2 * NE * I_W1E + NE * I_W2E;
    for (int it = gw; it < NITEMS; it += NGW) {
        int r = it;
        if (r < I_IN) { const int kb = r / 144, nb = r % 144; cvt_item(w_in + (size_t)(64 * kb) * NIN + 64 * nb, NIN, WIN + (size_t)(64 * nb) * D + 64 * kb, D, lane); continue; } r -= I_IN;
        if (r < I_PA) { const int kb = r / 32, nb = r % 32; cvt_item(wpa + (size_t)(64 * kb) * D + 64 * nb, D, WA + (size_t)(64 * nb) * ZW + 64 * kb, ZW, lane); continue; } r -= I_PA;
        if (r < I_PA) { const int kb = r / 32, nb = r % 32; cvt_item(wpb + (size_t)(64 * kb) * D + 64 * nb, D, WB + (size_t)(64 * nb) * ZW + 64 * kb, ZW, lane); continue; } r -= I_PA;
        if (r < I_OUT) { const int kb = r / 32, nb = r % 32; cvt_item(wout + (size_t)(64 * kb) * D + 64 * nb, D, WOUT + (size_t)(64 * nb) * D + 64 * kb, D, lane); continue; } r -= I_OUT;
        if (r < 2 * NE * I_W1E) { const int which = r / (NE * I_W1E); const int q = r % (NE * I_W1E); const int e = q / I_W1E, s = q % I_W1E; const int kb = s / 8, nb = s % 8;
            const float* src = (which ? w3 : w1) + (size_t)e * D * FF + (size_t)(64 * kb) * FF + 64 * nb; const int n0 = 64 * nb;
            const int drow = e * 1024 + (n0 >> 7) * 256 + which * 128 + (n0 & 127);
            cvt_item(src, FF, W13 + (size_t)drow * D + 64 * kb, D, lane); continue; } r -= 2 * NE * I_W1E;
        { const int e = r / I_W2E, s = r % I_W2E; const int kb = s / 32, nb = s % 32;
            cvt_item(w2 + (size_t)e * FF * D + (size_t)(64 * kb) * D + 64 * nb, D, W2T + ((size_t)e * D + 64 * nb) * FF + 64 * kb, FF, lane); }
    }
    { const float* sgw = inptr(I_SGW) + (size_t)l * 8 * 128 * 128; bf16_t* o = (bf16_t*)(ws + WS_SGW);
      for (int i = gw * 64 + lane; i < 8 * 128 * 128 / 2; i += NGW * 64) { const f32x2 v = *(const GAS f32x2*)(sgw + 2 * i); ((GAS unsigned*)o)[i] = cvt_pk_bf16(v.x, v.y); }
      const float* rgw = inptr(I_RGW) + (size_t)l * D * 4; const float* rew = inptr(I_REW) + (size_t)l * D * 16; const float* g2 = inptr(I_N2G) + (size_t)l * D;
      bf16_t* rh = (bf16_t*)(ws + WS_RWH); bf16_t* rl = (bf16_t*)(ws + WS_RWL);
      for (int i = gw * 64 + lane; i < 32 * D; i += NGW * 64) { const int c = i / D, k = i % D; float w = 0.f;
          if (c < 4) w = ((const GAS float*)rgw)[k * 4 + c] * ((const GAS float*)g2)[k]; else if (c < 20) w = ((const GAS float*)rew)[k * 16 + (c - 4)] * ((const GAS float*)g2)[k];
          const unsigned hb = cvt_pk_bf16(w, 0.f) & 0xffffu; const float hf = __uint_as_float(hb << 16); const unsigned lb = cvt_pk_bf16(w - hf, 0.f) & 0xffffu;
          ((GAS bf16_t*)rh)[i] = (bf16_t)hb; ((GAS bf16_t*)rl)[i] = (bf16_t)lb; } }
    const float* g1 = inptr(I_N1G) + (size_t)l * D; bf16_t* H = (bf16_t*)(ws + WS_H);
    for (int m = gw; m < T; m += NGW) rms_row_bf16(xin + (size_t)m * D, g1, H + (size_t)m * D, lane);
}

__device__ __forceinline__ void sgu_unit(unsigned char* ws, int l, int chunk, LAS unsigned char* lds, const int wid) {
    int lane_ = lane_now(); asm volatile("" : "+v"(lane_));
    const int lane = lane_, tid = wid * 64 + lane, r32 = lane & 31, hi = lane >> 5;
    bf16_t* GU = (bf16_t*)(ws + WS_Z); const bf16_t* GV = GU + ZSTRIDE; const bf16_t* KB = GU + 3 * ZSTRIDE;
    const bf16_t* WS_ = (const bf16_t*)(ws + WS_SGW);
    const float* lng = inptr(I_LNG) + (size_t)l * ZW; const float* lnb = inptr(I_LNB) + (size_t)l * ZW; const float* sgb = inptr(I_SGB) + (size_t)l * 8 * 128;
    gu32* ctl = (gu32*)(ws + WS_CTL);
    const int t0 = chunk * 128;
    LAS f32x2* stats = (LAS f32x2*)(lds);
    constexpr int VROW = 272;
    LAS unsigned char* vnT0 = lds + 2048;
    { const int row = tid >> 2, part = tid & 3;
      const GAS u32x4* gp = (const GAS u32x4*)(GV + (size_t)(t0 + row) * ZW + part * 256);
      float s = 0.f, ss = 0.f;
#pragma unroll 8
      for (int i = 0; i < 32; ++i) { const u32x4 w = gp[i];
#pragma unroll
          for (int e = 0; e < 4; ++e) { const float a = bf_lo(w[e]), b = bf_hi(w[e]); s += a + b; ss += a * a + b * b; } }
      s += shx(s, 1, lane); s += shx(s, 2, lane); ss += shx(ss, 1, lane); ss += shx(ss, 2, lane);
      const float mean = s * (1.f / ZW); const float var = fmaxf(ss * (1.f / ZW) - mean * mean, 0.f);
      if (part == 0) stats[row] = (f32x2){mean, 1.0f / sqrtf(var + LN_EPS)};
      const GAS u32x4* kp = (const GAS u32x4*)(KB + (size_t)(t0 + row) * ZW + part * 256);
      float kn[4];
#pragma unroll
      for (int q = 0; q < 4; ++q) { float a2 = 0.f;
#pragma unroll
          for (int i = 0; i < 8; ++i) { const u32x4 w = kp[q * 8 + i];
#pragma unroll
              for (int e = 0; e < 4; ++e) { const float a = bf_lo(w[e]), b = bf_hi(w[e]); a2 += a * a + b * b; } }
          kn[q] = a2; }
#pragma unroll
      for (int q = 0; q < 4; ++q) {
#pragma unroll
          for (int o = 4; o < 64; o <<= 1) kn[q] = fmaxf(kn[q], shx(kn[q], o, lane));
      }
      if (lane < 4) { const int b = t0 / SEQ;
#pragma unroll
          for (int q = 0; q < 4; ++q) atomicMax((unsigned*)(ctl + CW_KN + 64 * l) + b * 16 + part * 4 + q, __float_as_uint(kn[q])); }
    }
    __syncthreads();
    const int tb = wid & 3, cb0 = 2 * (wid >> 2);
    for (int g = 0; g < 8; ++g) {
        LAS unsigned char* vnT = vnT0 + (g & 1) * (128 * VROW);
#pragma unroll
        for (int i = 0; i < 4; ++i) { const int idx = tid + 512 * i; const int s = idx >> 4, cc = (idx & 15) * 8;
            const u32x4 w = *(const GAS u32x4*)(GV + (size_t)(t0 + s) * ZW + g * 128 + cc);
            const f32x2 st = stats[s];
            const f32x4 ga = *(const GAS f32x4*)(lng + g * 128 + cc), gb = *(const GAS f32x4*)(lng + g * 128 + cc + 4), ba = *(const GAS f32x4*)(lnb + g * 128 + cc), bb = *(const GAS f32x4*)(lnb + g * 128 + cc + 4);
            float y[8];
#pragma unroll
            for (int e = 0; e < 4; ++e) { y[2 * e] = bf_lo(w[e]); y[2 * e + 1] = bf_hi(w[e]); }
#pragma unroll
            for (int e = 0; e < 8; ++e) { const float gg = e < 4 ? ga[e & 3] : gb[e & 3], bbv = e < 4 ? ba[e & 3] : bb[e & 3]; y[e] = (y[e] - st.x) * st.y * gg + bbv; }
#pragma unroll
            for (int e = 0; e < 8; e += 2) { const unsigned pk = cvt_pk_bf16(y[e], y[e + 1]);
                *(LAS bf16_t*)(vnT + (cc + e) * VROW + s * 2) = (bf16_t)(pk & 0xffffu); *(LAS bf16_t*)(vnT + (cc + e + 1) * VROW + s * 2) = (bf16_t)(pk >> 16); } }
        __syncthreads();
        f32x16 acc0 = {}, acc1 = {};
        const bf16_t* arow = WS_ + ((size_t)(g * 128 + tb * 32 + r32)) * 128 + 8 * hi;
#pragma unroll
        for (int ks = 0; ks < 8; ++ks) {
            const bf16x8 a = *(const GAS bf16x8*)(arow + ks * 16);
            const bf16x8 b0 = *(const LAS bf16x8*)(vnT + (cb0 * 32 + r32) * VROW + (ks * 16 + 8 * hi) * 2);
            const bf16x8 b1 = *(const LAS bf16x8*)(vnT + ((cb0 + 1) * 32 + r32) * VROW + (ks * 16 + 8 * hi) * 2);
            acc0 = __builtin_amdgcn_mfma_f32_32x32x16_bf16(a, b0, acc0, 0, 0, 0);
            acc1 = __builtin_amdgcn_mfma_f32_32x32x16_bf16(a, b1, acc1, 0, 0, 0);
        }
#pragma unroll
        for (int r = 0; r < 16; ++r) { const int t = tb * 32 + (r & 3) + 8 * (r >> 2) + 4 * hi; const float bs = ((const GAS float*)sgb)[g * 128 + t];
            GAS bf16_t* p0 = (GAS bf16_t*)GU + (size_t)(t0 + t) * ZW + g * 128 + cb0 * 32 + r32; GAS bf16_t* p1 = p0 + 32;
            const float u0 = __uint_as_float((unsigned)*p0 << 16), u1 = __uint_as_float((unsigned)*p1 << 16);
            const unsigned pk = cvt_pk_bf16(u0 * (acc0[r] + bs), u1 * (acc1[r] + bs));
            *p0 = (bf16_t)(pk & 0xffffu); *p1 = (bf16_t)(pk >> 16); }
    }
    __syncthreads();
}

namespace att {
constexpr int SLOT = 32768;
constexpr int NSLOT = 3;
constexpr int LDS_WS = NSLOT * SLOT;
constexpr int LDS_GAP = LDS_WS + 8 * 256;
constexpr int CROWS = 132;
__device__ __forceinline__ int crow(int r, int hi) { return (r & 3) + 8 * (r >> 2) + 4 * hi; }
__device__ __forceinline__ void glds16(const void* gsrc, unsigned lds_dst) { unsigned keep;
    asm volatile("s_mov_b32 %0, m0\n\ts_mov_b32 m0, %2\n\ts_nop 0\n\tglobal_load_lds_dwordx4 %1, off\n\ts_mov_b32 m0, %0" : "=&s"(keep) : "v"(gsrc), "s"(lds_dst) : "memory"); }

__device__ __forceinline__ void unit(unsigned char* ws, int l, int b, int h, int qb, float lam, float one_m_laminit, LAS unsigned char* lds, const int wid) {
    int lane_ = lane_now(); asm volatile("" : "+v"(lane_));
    const int lane = lane_, tid = wid * 64 + lane, r32 = lane & 31, hi = lane >> 5;
    const int map = wid >> 2, wq = wid & 3;
    bf16_t* QB = (bf16_t*)(ws + WS_Z) + 2 * ZSTRIDE; const bf16_t* KB = QB + ZSTRIDE; const bf16_t* VB = QB + 2 * ZSTRIDE;
    const gu32* ctl = (const gu32*)(ws + WS_CTL);
    const long rowbase = (long)b * SEQ; const int q0 = qb * 128; const int qrow = q0 + wq * 32 + r32;
    const unsigned lds0 = (unsigned)(uintptr_t)lds;
    LAS float* wsf = (LAS float*)(lds + LDS_WS) + wid * 64;
    LAS float* gaps = (LAS float*)(lds + LDS_GAP);
    const bf16_t* ksrc = KB + (rowbase + lane) * ZW + h * 128 + (2 * wid) * 8;
    const int vp0 = 2 * wid, vp1 = 2 * wid + 1;
    const bf16_t* vsrc0 = VB + (rowbase + 16 * (vp0 & 3) + (lane >> 2)) * ZW + h * 128 + (vp0 >> 2) * 32 + (lane & 3) * 8;
    const bf16_t* vsrc1 = VB + (rowbase + 16 * (vp1 & 3) + (lane >> 2)) * ZW + h * 128 + (vp1 >> 2) * 32 + (lane & 3) * 8;
#define ATT_DMA(j, slot) do { const long ko_ = (long)(j) * 64 * ZW; const unsigned sb_ = lds0 + (unsigned)(slot) * SLOT; \
        glds16(ksrc + ko_, (unsigned)__builtin_amdgcn_readfirstlane(sb_ + (2 * wid) * 1024)); glds16(ksrc + ko_ + 8, (unsigned)__builtin_amdgcn_readfirstlane(sb_ + (2 * wid + 1) * 1024)); \
        glds16(vsrc0 + ko_, (unsigned)__builtin_amdgcn_readfirstlane(sb_ + 16384 + vp0 * 1024)); glds16(vsrc1 + ko_, (unsigned)__builtin_amdgcn_readfirstlane(sb_ + 16384 + vp1 * 1024)); } while (0)
    const int jc0 = q0 >> 6;
    ATT_DMA(jc0, 0);
    bf16x8 qr[4];
    { const bf16_t* qp = QB + (rowbase + qrow) * ZW + h * 128 + map * 64 + 8 * hi;
#pragma unroll
      for (int d0 = 0; d0 < 4; ++d0) qr[d0] = *(const GAS bf16x8*)(qp + d0 * 16); }
    float qn2 = 0.f;
#pragma unroll
    for (int d0 = 0; d0 < 4; ++d0)
#pragma unroll
        for (int e = 0; e < 8; ++e) { const float v = __uint_as_float((unsigned)(unsigned short)qr[d0][e] << 16); qn2 += v * v; }
    qn2 += shx(qn2, 32, lane);
    const float qn2max = wave_max(qn2, lane);
    const float kn2 = __uint_as_float(__hip_atomic_load(ctl + CW_KN + 64 * l + b * 16 + h * 2 + map, RLX_AGENT));
    const float ub = sqrtf(qn2max * kn2) * 1.001f + 0.5f;
    const float slope2 = exp2f(-(float)(h + 1)) * LOG2E;
    if (tid < 16) gaps[tid] = 1e30f;
    float kvl[16];
#pragma unroll
    for (int r = 0; r < 16; ++r) kvl[r] = (float)crow(r, hi);
    float m_run = -1e30f, l_run = 0.f;
    f32x16 o[4];
#pragma unroll
    for (int d = 0; d < 4; ++d) o[d] = (f32x16){};
    const unsigned vb0 = lds0 + 16384 + ((lane >> 4) & 1) * 32 + (lane & 3) * 8 + (4 * hi + ((lane & 15) >> 2)) * 64;
    int cur = jc0, slot = 0, it = 0, dir = 0, jl = jc0 - 1, jr = jc0 + 2;
    __syncthreads();
    for (;;) {
        int nxt = -1;
        if (it == 0) nxt = jc0 + 1;
        else {
            float gmax = -1e30f;
            { const LAS float* gp = gaps + (it & 1) * 8;
#pragma unroll
              for (int w = 0; w < 8; ++w) gmax = fmaxf(gmax, gp[w]); }
            gmax = __builtin_amdgcn_readfirstlane(gmax);
            if (dir == 0) dir = 1;
            if (dir == 1) { if (jl >= 0 && !(gmax - slope2 * (float)(q0 - (64 * jl + 63)) < -SKIP_T2)) { nxt = jl; --jl; } else dir = 2; }
            if (dir == 2) { if (jr < SEQ / 64 && !(gmax - slope2 * (float)(64 * jr - (q0 + 127)) < -SKIP_T2)) { nxt = jr; ++jr; } else dir = 3; }
        }
        const int nslot = slot == NSLOT - 1 ? 0 : slot + 1;
        if (nxt >= 0) { ATT_DMA(nxt, nslot); asm volatile("s_waitcnt vmcnt(4) lgkmcnt(0)" ::: "memory"); }
        else asm volatile("s_waitcnt vmcnt(0) lgkmcnt(0)" ::: "memory");
        __builtin_amdgcn_s_barrier(); asm volatile("" ::: "memory");
        f32x16 p0 = {}, p1 = {};
        { const LAS unsigned char* kb = lds + slot * SLOT + (8 * map + hi) * 1024 + r32 * 16;
#pragma unroll
          for (int d0 = 0; d0 < 4; ++d0) {
              const bf16x8 k0 = *(const LAS bf16x8*)(kb + d0 * 2048), k1 = *(const LAS bf16x8*)(kb + d0 * 2048 + 512);
              p0 = __builtin_amdgcn_mfma_f32_32x32x16_bf16(k0, qr[d0], p0, 0, 0, 0); p1 = __builtin_amdgcn_mfma_f32_32x32x16_bf16(k1, qr[d0], p1, 0, 0, 0); } }
        { const float x = (float)(64 * cur - qrow);
#pragma unroll
          for (int r = 0; r < 16; ++r) { p0[r] = p0[r] - slope2 * fabsf(x + kvl[r]); p1[r] = p1[r] - slope2 * fabsf(x + 32.0f + kvl[r]); } }
        float rm = fmaxf(p0[0], p1[0]);
#pragma unroll
        for (int r = 1; r < 16; ++r) rm = fmaxf(rm, fmaxf(p0[r], p1[r]));
        rm = fmaxf(rm, shx(rm, 32, lane));
        const float mnew = fmaxf(m_run, rm);
        if (__any(mnew > m_run)) {
            const float f = __builtin_amdgcn_exp2f(m_run - mnew); l_run *= f; m_run = mnew;
            if (hi == 0) wsf[r32] = f;
            asm volatile("s_waitcnt lgkmcnt(0)" ::: "memory");
#pragma unroll
            for (int r = 0; r < 16; ++r) { const float fr_ = wsf[crow(r, hi)];
#pragma unroll
                for (int d = 0; d < 4; ++d) o[d][r] *= fr_; }
        }
        float sacc = 0.f;
#pragma unroll
        for (int r = 0; r < 16; ++r) { p0[r] = __builtin_amdgcn_exp2f(p0[r] - m_run); p1[r] = __builtin_amdgcn_exp2f(p1[r] - m_run); sacc += p0[r] + p1[r]; }
        l_run += sacc;
        u32x4 pw0, pw1, pw2, pw3;
        pw0 = (u32x4){cvt_pk_bf16(p0[0], p0[1]), cvt_pk_bf16(p0[2], p0[3]), cvt_pk_bf16(p0[4], p0[5]), cvt_pk_bf16(p0[6], p0[7])};
        pw1 = (u32x4){cvt_pk_bf16(p0[8], p0[9]), cvt_pk_bf16(p0[10], p0[11]), cvt_pk_bf16(p0[12], p0[13]), cvt_pk_bf16(p0[14], p0[15])};
        pw2 = (u32x4){cvt_pk_bf16(p1[0], p1[1]), cvt_pk_bf16(p1[2], p1[3]), cvt_pk_bf16(p1[4], p1[5]), cvt_pk_bf16(p1[6], p1[7])};
        pw3 = (u32x4){cvt_pk_bf16(p1[8], p1[9]), cvt_pk_bf16(p1[10], p1[11]), cvt_pk_bf16(p1[12], p1[13]), cvt_pk_bf16(p1[14], p1[15])};
        { const unsigned vb = vb0 + (unsigned)slot * SLOT;
#pragma unroll
          for (int d0 = 0; d0 < 4; ++d0) { s16x4 lo[4], hh[4];
#pragma unroll
              for (int ks = 0; ks < 4; ++ks) {
                  asm volatile("ds_read_b64_tr_b16 %0,%1 offset:%c2" : "=&v"(lo[ks]) : "v"(vb), "i"(d0 * 4096 + ks * 1024) : "memory");
                  asm volatile("ds_read_b64_tr_b16 %0,%1 offset:%c2" : "=&v"(hh[ks]) : "v"(vb), "i"(d0 * 4096 + ks * 1024 + 512) : "memory"); }
              asm volatile("s_waitcnt lgkmcnt(0)" ::: "memory"); __builtin_amdgcn_sched_barrier(0);
#define ATT_PK(k) (bf16x8){lo[k][0], lo[k][1], lo[k][2], lo[k][3], hh[k][0], hh[k][1], hh[k][2], hh[k][3]}
              o[d0] = __builtin_amdgcn_mfma_f32_32x32x16_bf16(__builtin_bit_cast(bf16x8, pw0), ATT_PK(0), o[d0], 0, 0, 0);
              o[d0] = __builtin_amdgcn_mfma_f32_32x32x16_bf16(__builtin_bit_cast(bf16x8, pw1), ATT_PK(1), o[d0], 0, 0, 0);
              o[d0] = __builtin_amdgcn_mfma_f32_32x32x16_bf16(__builtin_bit_cast(bf16x8, pw2), ATT_PK(2), o[d0], 0, 0, 0);
              o[d0] = __builtin_amdgcn_mfma_f32_32x32x16_bf16(__builtin_bit_cast(bf16x8, pw3), ATT_PK(3), o[d0], 0, 0, 0);
#undef ATT_PK
          } }
        { float mmin = m_run;
#pragma unroll
          for (int off = 1; off < 64; off <<= 1) mmin = fminf(mmin, shx(mmin, off, lane));
          if (lane == 0) gaps[(it & 1) * 8 + wid] = ub - mmin; }
        if (nxt < 0) break;
        cur = nxt; slot = nslot; ++it;
    }
    l_run += shx(l_run, 32, lane);
    if (hi == 0) wsf[32 + r32] = l_run;
    asm volatile("s_waitcnt lgkmcnt(0)" ::: "memory");
    __syncthreads();
    LAS float* comb = (LAS float*)lds + wq * (32 * CROWS);
    if (map == 1) {
#pragma unroll
        for (int r = 0; r < 16; ++r) { const float sc = -lam * __builtin_amdgcn_rcpf(wsf[32 + crow(r, hi)]);
#pragma unroll
            for (int d = 0; d < 4; ++d) comb[crow(r, hi) * CROWS + d * 32 + r32] = o[d][r] * sc; }
    }
    __syncthreads();
    if (map == 0) {
#pragma unroll
        for (int r = 0; r < 16; ++r) { const float sc = __builtin_amdgcn_rcpf(wsf[32 + crow(r, hi)]);
#pragma unroll
            for (int d = 0; d < 4; ++d) { LAS float* p = comb + crow(r, hi) * CROWS + d * 32 + r32; *p = *p + o[d][r] * sc; } }
        asm volatile("s_waitcnt lgkmcnt(0)" ::: "memory");
        const int row = lane >> 1, half = lane & 1;
        const LAS f32x4* rp = (const LAS f32x4*)(comb + row * CROWS + half * 64);
        f32x4 v[16]; float ss = 0.f;
#pragma unroll
        for (int i = 0; i < 16; ++i) { v[i] = rp[i]; ss += (v[i].x * v[i].x + v[i].y * v[i].y) + (v[i].z * v[i].z + v[i].w * v[i].w); }
        ss += shx(ss, 1, lane);
        const float rs = one_m_laminit / sqrtf(ss * (1.f / 128.f) + RMS_EPS);
        const float* gd = inptr(I_DNG) + (size_t)l * 128 + half * 64;
        bf16_t* op = QB + (rowbase + q0 + wq * 32 + row) * ZW + h * 128 + half * 64;
#pragma unroll
        for (int i = 0; i < 8; ++i) { const f32x4 ga = *(const GAS f32x4*)(gd + 8 * i), gb = *(const GAS f32x4*)(gd + 8 * i + 4);
            *(GAS u32x4*)(op + 8 * i) = pg8::pack8(v[2 * i] * rs * ga, v[2 * i + 1] * rs * gb); }
    }
    __syncthreads();
#undef ATT_DMA
}
}

__device__ __forceinline__ void router_block(unsigned char* ws, int l, int blk, const float* x, LAS float* scr  , int lane) {
    const int r32 = lane & 31, hi = lane >> 5;
    const bf16_t* rh = (const bf16_t*)(ws + WS_RWH); const bf16_t* rl = (const bf16_t*)(ws + WS_RWL);
    const float* xr = x + (size_t)(blk * 32 + r32) * D + 16 * hi;
    const bf16_t* wh = rh + (size_t)r32 * D + 16 * hi; const bf16_t* wl = rl + (size_t)r32 * D + 16 * hi;
    f32x16 acc = {}; float ss = 0.f;
#pragma unroll 2
    for (int s = 0; s < 64; ++s) {
        const f32x4 a0 = *(const GAS f32x4*)(xr + 32 * s), a1 = *(const GAS f32x4*)(xr + 32 * s + 4), a2 = *(const GAS f32x4*)(xr + 32 * s + 8), a3 = *(const GAS f32x4*)(xr + 32 * s + 12);
        const bf16x8 bh0 = *(const GAS bf16x8*)(wh + 32 * s), bh1 = *(const GAS bf16x8*)(wh + 32 * s + 8), bl0 = *(const GAS bf16x8*)(wl + 32 * s), bl1 = *(const GAS bf16x8*)(wl + 32 * s + 8);
        ss += (a0.x * a0.x + a0.y * a0.y) + (a0.z * a0.z + a0.w * a0.w) + (a1.x * a1.x + a1.y * a1.y) + (a1.z * a1.z + a1.w * a1.w)
            + (a2.x * a2.x + a2.y * a2.y) + (a2.z * a2.z + a2.w * a2.w) + (a3.x * a3.x + a3.y * a3.y) + (a3.z * a3.z + a3.w * a3.w);
        u32x4 h0, h1, l0, l1;
#define RT_SPLIT(v, H, L, i) do { const unsigned hp = cvt_pk_bf16(v.x, v.y), hq = cvt_pk_bf16(v.z, v.w); H[i] = hp; H[i + 1] = hq; \
            L[i] = cvt_pk_bf16(v.x - bf_lo(hp), v.y - bf_hi(hp)); L[i + 1] = cvt_pk_bf16(v.z - bf_lo(hq), v.w - bf_hi(hq)); } while (0)
        RT_SPLIT(a0, h0, l0, 0); RT_SPLIT(a1, h0, l0, 2); RT_SPLIT(a2, h1, l1, 0); RT_SPLIT(a3, h1, l1, 2);
#undef RT_SPLIT
        const bf16x8 ah0 = __builtin_bit_cast(bf16x8, h0), ah1 = __builtin_bit_cast(bf16x8, h1), al0 = __builtin_bit_cast(bf16x8, l0), al1 = __builtin_bit_cast(bf16x8, l1);
        acc = __builtin_amdgcn_mfma_f32_32x32x16_bf16(ah0, bh0, acc, 0, 0, 0); acc = __builtin_amdgcn_mfma_f32_32x32x16_bf16(ah0, bl0, acc, 0, 0, 0); acc = __builtin_amdgcn_mfma_f32_32x32x16_bf16(al0, bh0, acc, 0, 0, 0);
        acc = __builtin_amdgcn_mfma_f32_32x32x16_bf16(ah1, bh1, acc, 0, 0, 0); acc = __builtin_amdgcn_mfma_f32_32x32x16_bf16(ah1, bl1, acc, 0, 0, 0); acc = __builtin_amdgcn_mfma_f32_32x32x16_bf16(al1, bh1, acc, 0, 0, 0);
    }
    ss += shx(ss, 32, lane);
    const float rstd = 1.0f / sqrtf(ss * (1.f / D) + RMS_EPS);
#pragma unroll
    for (int r = 0; r < 16; ++r) scr[((r & 3) + 8 * (r >> 2) + 4 * hi) * 33 + r32] = acc[r];
    asm volatile("s_waitcnt lgkmcnt(0)" ::: "memory");
    if (lane < 32) {
        const float* rgb = inptr(I_RGB) + l * 4; const float* reb = inptr(I_REB) + l * 16;
        float gl[4];
#pragma unroll
        for (int c = 0; c < 4; ++c) gl[c] = scr[r32 * 33 + c] * rstd + ((const GAS float*)rgb)[c];
        int g = 0; float gm = gl[0];
#pragma unroll
        for (int c = 1; c < 4; ++c) if (gl[c] > gm) { gm = gl[c]; g = c; }
        float gs = 0.f;
#pragma unroll
        for (int c = 0; c < 4; ++c) gs += expf(gl[c] - gm);
        const float gw = 1.0f / gs;
        float el[4];
#pragma unroll
        for (int c = 0; c < 4; ++c) { float v = 0.f;
#pragma unroll
            for (int gg = 0; gg < 4; ++gg) v = (g == gg) ? scr[r32 * 33 + 4 + gg * 4 + c] * rstd + ((const GAS float*)reb)[gg * 4 + c] : v;
            el[c] = v; }
        int i1 = 0; float m1 = el[0];
#pragma unroll
        for (int c = 1; c < 4; ++c) if (el[c] > m1) { m1 = el[c]; i1 = c; }
        int i2 = -1; float m2 = -3.0e38f;
#pragma unroll
        for (int c = 0; c < 4; ++c) if (c != i1 && el[c] > m2) { m2 = el[c]; i2 = c; }
        const float e2 = expf(m2 - m1); const float w1 = 1.0f / (1.0f + e2), w2 = e2 / (1.0f + e2);
        const int lo = i1 < i2 ? i1 : i2, hi_ = i1 < i2 ? i2 : i1; const float clo = gw * (i1 < i2 ? w1 : w2), chi = gw * (i1 < i2 ? w2 : w1);
        const int pair = lo == 0 ? hi_ - 1 : (lo == 1 ? hi_ + 1 : 5);
        const int tok = blk * 32 + r32;
        gu32* ctl = (gu32*)(ws + WS_CTL); GAS float* tokc = (GAS float*)(ws + WS_TOKC); GAS int* liste = (GAS int*)(ws + WS_LISTE); GAS int* listc = (GAS int*)(ws + WS_LISTC);
        tokc[tok * 2] = clo; tokc[tok * 2 + 1] = chi;
        const int elo = g * 4 + lo, ehi = g * 4 + hi_, cls = g * 6 + pair;
        const unsigned p0 = __hip_atomic_fetch_add((unsigned*)(ctl + CW_CNTE + 2048 * l + 64 * elo), 1u, RLX_AGENT); liste[(size_t)elo * T + p0] = tok * 2;
        const unsigned p1 = __hip_atomic_fetch_add((unsigned*)(ctl + CW_CNTE + 2048 * l + 64 * ehi), 1u, RLX_AGENT); liste[(size_t)ehi * T + p1] = tok * 2 + 1;
        const unsigned p2 = __hip_atomic_fetch_add((unsigned*)(ctl + CW_CNTC + 2048 * l + 64 * cls), 1u, RLX_AGENT); listc[(size_t)cls * T + p2] = tok;
    }
}

__device__ __forceinline__ void moe_setup(LAS int* tab, const gu32* cnt, int nl, int tid) {
    if (tid < nl) tab[32 + tid] = (int)__hip_atomic_load(cnt + 64 * tid, RLX_AGENT);
    __syncthreads();
    if (tid == 0) { int s = 0; for (int j = 0; j < nl; ++j) { tab[j] = s; s += (tab[32 + j] + 255) >> 8; } tab[nl] = s; }
    __syncthreads();
}

constexpr int NPHASE = DEPTH * 10 + 1;
__global__ void __launch_bounds__(512, 2) mk_fwd(Ptrs P) {
    extern __shared__ __attribute__((aligned(16))) unsigned char lds_raw[];
    LAS unsigned char* lds = (LAS unsigned char*)lds_raw;
    const int wave = __builtin_amdgcn_readfirstlane((int)threadIdx.x >> 6);
    const int G = gridDim.x; const int bx = blockIdx.x;
    volatile LAS unsigned* MISC = (volatile LAS unsigned*)(lds + MISC_OFF);
    for (int u = threadIdx.x; u < (LDS_BYTES - LDSCTL_OFF) / 4; u += 512) ((LAS unsigned*)(lds + LDSCTL_OFF))[u] = 0u;
    __syncthreads();
    if (MK_N_LAUNCHES == 1) (void)xcd_barrier_post((unsigned*)(P.ws + WS_CTL) + CW_BAR, MISC);
    const int lo = P.ph_lo, hi = P.ph_hi;
#ifndef DBG_ONLY
#define DBG_ONLY -1
#endif
#define IN(k) ((DBG_ONLY < 0 || DBG_ONLY == ((k) % 10)) && lo <= (k) && (k) < hi)
#define SEAM(k) do { if (IN(k) && IN((k) + 1)) { XcdBarrier b_; b_.bar = (unsigned*)(P.ws + WS_CTL) + CW_BAR; b_.x = xb_xcc_id(); b_.st = MISC; xcd_barrier(b_, wave == 0 && lane_now() == 0); } } while (0)
#define OPQ_S(x) asm volatile("" : "+s"(x))
#define OPQ_V(x) asm volatile("" : "+v"(x))
#define PH_LOCALS unsigned char* ws = P.ws; OPQ_S(ws); ws = (unsigned char*)(GAS unsigned char*)ws; float* outp = P.out; OPQ_S(outp); outp = (float*)(GAS float*)outp;   int Gl = G; OPQ_S(Gl); int bxl = bx; OPQ_S(bxl); int ln = lane_now(); OPQ_V(ln); \
    const int vcu = (Gl % 8 == 0) ? (bxl % 8) * (Gl / 8) + bxl / 8 : bxl; const int gw = vcu * 8 + wave, NGW = Gl * 8; (void)gw; (void)NGW; (void)ln; (void)outp; \
    gu32* ctl = (gu32*)(ws + WS_CTL); (void)ctl; bf16_t* H = (bf16_t*)(ws + WS_H); (void)H; bf16_t* ZB = (bf16_t*)(ws + WS_Z); (void)ZB; bf16_t* GB = (bf16_t*)(ws + WS_G); (void)GB; \
    bf16_t* H2 = ZB; (void)H2; bf16_t* HID = ZB + 3 * ZSTRIDE; (void)HID;
    for (int l = 0; l < DEPTH; ++l) {
        const int pb = l * 10;
        if (IN(pb + 0)) { PH_LOCALS; const float* xin = (l == 0) ? inptr(I_X) : outp; p0_convert_norm(ws, l, xin, gw, NGW, ln); }
        SEAM(pb + 0);
        if (IN(pb + 1)) { PH_LOCALS;
            pg8::DenseOrder S; S.init(T, NIN, Gl, bxl, (const bf16_t*)(ws + WS_WIN), D);
            pg8::EpiZ E{ZB, GB, inptr(I_BGATE) + (size_t)l * 2 * D};
            pg8::gemm_phase<pg8::EpiZ, pg8::DenseOrder, true>(lds, wave, H, D, D, D, S, E);
        }
        SEAM(pb + 1);
        if (IN(pb + 2)) { PH_LOCALS; for (int c = vcu; c < T / 128; c += Gl) sgu_unit(ws, l, c, lds, wave); }
        SEAM(pb + 2);
        if (IN(pb + 3)) { PH_LOCALS;
            pg8::DenseOrder S; S.init(T, D, Gl, bxl, (const bf16_t*)(ws + WS_WA), ZW);
            pg8::EpiProj<false> E{H, GB, 0};
            pg8::gemm_phase<pg8::EpiProj<false>, pg8::DenseOrder, true>(lds, wave, ZB, ZW, ZW, ZW, S, E);
        }
        if (IN(pb + 4)) { PH_LOCALS;
            float lam, oml;
            { const float* q1 = inptr(I_LQ1) + l * 64; const float* k1 = inptr(I_LK1) + l * 64; const float* q2 = inptr(I_LQ2) + l * 64; const float* k2 = inptr(I_LK2) + l * 64;
              const float s1 = wave_sum(((const GAS float*)q1)[ln] * ((const GAS float*)k1)[ln], ln), s2 = wave_sum(((const GAS float*)q2)[ln] * ((const GAS float*)k2)[ln], ln);
              const float lam_init = 0.8f - 0.6f * expf(-0.3f * (float)l);
              lam = expf(s1) - expf(s2) + lam_init; oml = 1.0f - lam_init; }
            for (;;) {
                if (wave == 0 && ln == 0) MISC[2] = __hip_atomic_fetch_add((unsigned*)(ctl + CW_AQ + 64 * l), 1u, RLX_AGENT);
                __syncthreads();
                const int i = (int)MISC[2];
                __syncthreads();
                if (i >= BATCH * NH * (SEQ / 128)) break;
                const int h = NH - 1 - (i >> 8), rem = i & 255;
                att::unit(ws, l, rem >> 7, h, rem & 127, lam, oml, lds, wave);
            }
        }
        SEAM(pb + 4);
        if (IN(pb + 5)) { PH_LOCALS;
            pg8::DenseOrder S; S.init(T, D, Gl, bxl, (const bf16_t*)(ws + WS_WB), ZW);
            pg8::EpiProj<true> E{H, GB, D};
            pg8::gemm_phase<pg8::EpiProj<true>, pg8::DenseOrder, true>(lds, wave, ZB + 2 * ZSTRIDE, ZW, ZW, ZW, S, E);
        }
        SEAM(pb + 5);
        if (IN(pb + 6)) { PH_LOCALS; const float* xin = (l == 0) ? inptr(I_X) : outp;
            pg8::DenseOrder S; S.init(T, D, Gl, bxl, (const bf16_t*)(ws + WS_WOUT), D);
            pg8::EpiRes E{xin, outp};
            pg8::gemm_phase<pg8::EpiRes, pg8::DenseOrder, true>(lds, wave, H, D, D, D, S, E);
        }
        SEAM(pb + 6);
        if (IN(pb + 7)) { PH_LOCALS;
            const float* g2 = inptr(I_N2G) + (size_t)l * D;
            for (int m = gw; m < T; m += NGW) rms_row_bf16(outp + (size_t)m * D, g2, H2 + (size_t)m * D, ln);
            LAS float* scr = (LAS float*)lds + wave * (32 * 33);
            for (int blk = gw; blk < T / 32; blk += NGW) router_block(ws, l, blk, outp, scr, ln);
        }
        SEAM(pb + 7);
        if (IN(pb + 8)) { PH_LOCALS;
            LAS int* tab = (LAS int*)(lds + MOETAB_OFF);
            moe_setup(tab, ctl + CW_CNTE + 2048 * l, NE, wave * 64 + ln);
            pg8::UpOrder S{Gl, bxl, tab, (const int*)(ws + WS_LISTE), (const char*)(ws + WS_W13)};
            pg8::EpiUp E{HID, (const float*)(ws + WS_TOKC), (const int*)(ws + WS_LISTE)};
            pg8::gemm_phase<pg8::EpiUp, pg8::UpOrder, true>(lds, wave, H2, D, D, D, S, E);
        }
        SEAM(pb + 8);
        if (IN(pb + 9)) { PH_LOCALS;
            LAS int* tab = (LAS int*)(lds + MOETAB_OFF);
            moe_setup(tab, ctl + CW_CNTC + 2048 * l, NCLS, wave * 64 + ln);
            pg8::DownOrder S{Gl, bxl, tab, (const int*)(ws + WS_LISTC), (const char*)(ws + WS_W2T)};
            pg8::EpiDown E{outp, (const int*)(ws + WS_LISTC)};
            pg8::gemm_phase<pg8::EpiDown, pg8::DownOrder, true>(lds, wave, HID, 2 * FF, FF, 2 * FF, S, E);
        }
        SEAM(pb + 9);
    }
#if defined(DIAG_DUMP_MIB)
    if (lo == 1000) { PH_LOCALS; const bf16_t* src = (const bf16_t*)(ws + (size_t)DIAG_DUMP_MIB * MiB);
        for (size_t i = (size_t)gw * 64 + ln; i < (size_t)T * D / 2; i += (size_t)NGW * 64) { const unsigned w = ((const GAS unsigned*)src)[i]; ((GAS float*)outp)[2 * i] = bf_lo(w); ((GAS float*)outp)[2 * i + 1] = bf_hi(w); } }
#endif
    if (IN(DEPTH * 10)) { PH_LOCALS; for (int m = gw; m < T; m += NGW) rms_row_f32(outp + (size_t)m * D, inptr(I_FG), outp + (size_t)m * D, ln); }
#undef IN
#undef SEAM
}

extern "C" void kernel_launch(void* const* d_in, const int* in_sizes, int n_in, void* d_out, int out_size, void* d_ws, size_t ws_size, hipStream_t stream) {
    static int grid = 0;
    if (grid == 0) {
        if (n_in != 25 || in_sizes[0] != T * D || out_size != T * D || ws_size < WS_END) { fprintf(stderr, "kernel_launch: unexpected shapes / workspace (n_in %d, ws %zu)\n", n_in, ws_size); grid = -1; return; }
        int dev = 0, cus = 0, per_cu = 0;
        if (hipGetDevice(&dev) != hipSuccess || hipDeviceGetAttribute(&cus, hipDeviceAttributeMultiprocessorCount, dev) != hipSuccess) { grid = -1; return; }
        if (hipFuncSetAttribute((const void*)mk_fwd, hipFuncAttributeMaxDynamicSharedMemorySize, LDS_BYTES) != hipSuccess) { fprintf(stderr, "kernel_launch: hipFuncSetAttribute failed\n"); grid = -1; return; }
        if (hipOccupancyMaxActiveBlocksPerMultiprocessor(&per_cu, (const void*)mk_fwd, 512, LDS_BYTES) != hipSuccess || per_cu < 1) { fprintf(stderr, "kernel_launch: occupancy query says %d\n", per_cu); }
        (void)hipGetLastError();
        grid = cus;
    }
    if (grid < 0) return;
    (void)hipMemsetAsync((char*)d_ws + WS_CTL, 0, CTL_ZERO_BYTES, stream);
    Ptrs p{};
    for (int i = 0; i < 25; ++i) p.in[i] = (const float*)d_in[i];
    p.out = (float*)d_out; p.ws = (unsigned char*)d_ws;
#if MK_N_LAUNCHES == 1
    p.ph_lo = 0; p.ph_hi = NPHASE;
    hipLaunchKernelGGL(mk_fwd, dim3(grid), dim3(512), LDS_BYTES, stream, p);
#else
#if defined(DIAG_STOP)
    for (int k = 0; k < DIAG_STOP; ++k) { p.ph_lo = k; p.ph_hi = k + 1; hipLaunchKernelGGL(mk_fwd, dim3(grid), dim3(512), LDS_BYTES, stream, p); }
#if defined(DIAG_DUMP_MIB)
    p.ph_lo = 1000; p.ph_hi = 1001; hipLaunchKernelGGL(mk_fwd, dim3(grid), dim3(512), LDS_BYTES, stream, p);
#endif
#else
    for (int k = 0; k < NPHASE; ++k) { p.ph_lo = k; p.ph_hi = k + 1; hipLaunchKernelGGL(mk_fwd, dim3(grid), dim3(512), LDS_BYTES, stream, p); }
#endif
#endif
}
```
